# Optimizing an MI355X kernel written in HIP

```python
import math
import jax, jax.numpy as jnp
from jax import lax
import numpy as np

D_MODEL = 1024
BATCH = 16
SEQ = 2048
DEPTH = 1
DEC_BATCH = 32
DEC_SEQ = 4
PAST_LEN = 16384
PAGE_SIZE = 128

D_ATT = D_MODEL // 2
N_HEADS_ATT = 8
HEAD_DIM_ATT = D_ATT // N_HEADS_ATT
D_MLSTM = D_MODEL - D_ATT
N_HEADS_MLSTM = 4
HEAD_DIM_MLSTM = D_MLSTM // N_HEADS_MLSTM
D_MIX = D_ATT + D_MLSTM
ROT_DIM = HEAD_DIM_ATT // 4
ROPE_THETA = 500000.0
DILATED_PATTERNS = ((128, 1), (512, 4), (2048, 16))
MAX_WINDOW = 2048
ATT_BLOCK = 128
CONV_WIDTH = 4
MLSTM_CHUNK = 128
EPS = 1e-6
NEG_INF = -1e30
SPLIT_SIZES = (D_ATT, D_ATT, D_ATT, D_ATT,
               D_MLSTM, D_MLSTM, D_MLSTM, D_MLSTM, D_MLSTM, N_HEADS_MLSTM, N_HEADS_MLSTM)
N_IN = sum(SPLIT_SIZES)

kernel_name = 'hymba_dilated_attn_mlstm_decode_step'


def rmsnorm(x, g):
    xf = x.astype(jnp.float32)
    y = xf * lax.rsqrt(jnp.mean(xf * xf, axis=-1, keepdims=True) + EPS)
    return (y * g.astype(jnp.float32)).astype(x.dtype)


def rope_partial(x, pos):
    half = ROT_DIM // 2
    inv = ROPE_THETA ** (-jnp.arange(half, dtype=jnp.float32) * 2.0 / ROT_DIM)
    ang = pos.astype(jnp.float32)[:, None] * inv[None, :]
    cos = jnp.cos(ang)[None, :, None, :]
    sin = jnp.sin(ang)[None, :, None, :]
    x1 = x[..., :half]
    x2 = x[..., half:ROT_DIM]
    return jnp.concatenate([x1 * cos - x2 * sin, x2 * cos + x1 * sin, x[..., ROT_DIM:]], axis=-1)


def dilated_partial_prompt(q, k, v, dil, n_back):
    B, S, H, D = q.shape
    L = S // dil
    nb = -(-L // ATT_BLOCK)
    Lp = nb * ATT_BLOCK

    def to_sub(t):
        t = t.reshape(B, L, dil, H, D).transpose(0, 2, 1, 3, 4)
        t = jnp.pad(t, ((0, 0), (0, 0), (0, Lp - L), (0, 0), (0, 0)))
        return t.reshape(B, dil, nb, ATT_BLOCK, H, D)

    qs, ks, vs = to_sub(q), to_sub(k), to_sub(v)

    def with_prev(t):
        prev = jnp.concatenate([jnp.zeros_like(t[:, :, :1]), t[:, :, :-1]], axis=2)
        return jnp.concatenate([prev, t], axis=3)

    kk, vv = with_prev(ks), with_prev(vs)
    s = jnp.einsum('brcqhe,brckhe->brchqk', qs, kk) * (HEAD_DIM_ATT ** -0.5)
    u = jnp.arange(ATT_BLOCK)[:, None]
    wk = jnp.arange(2 * ATT_BLOCK)[None, :]
    dist = u + ATT_BLOCK - wk
    in_win = (dist >= 0) & (dist <= n_back)
    has_prev = (jnp.arange(nb) > 0)[:, None, None] | (wk >= ATT_BLOCK)[None]
    valid = in_win[None] & has_prev
    s = jnp.where(valid[None, None, :, None], s, NEG_INF)
    m = jnp.max(s, axis=-1)
    p = jnp.exp(s - m[..., None])
    den = jnp.sum(p, axis=-1)
    acc = jnp.einsum('brchqk,brckhe->brcqhe', p, vv)

    def stat_back(t):
        t = t.transpose(0, 1, 2, 4, 3).reshape(B, dil, Lp, H)[:, :, :L]
        return t.transpose(0, 2, 1, 3).reshape(B, S, H)

    acc = acc.reshape(B, dil, Lp, H, D)[:, :, :L].transpose(0, 2, 1, 3, 4).reshape(B, S, H, D)
    return stat_back(m), stat_back(den), acc


def dilated_partial_sample(q, kc, vc, dil, n_back):
    T = q.shape[1]
    WB = kc.shape[1] - T
    j = jnp.arange(n_back + 1)
    idx = WB + jnp.arange(T)[:, None] - j[None, :] * dil
    valid = idx >= 0
    idx = jnp.maximum(idx, 0)
    kg = jnp.take(kc, idx, axis=1)
    vg = jnp.take(vc, idx, axis=1)
    s = jnp.einsum('bthe,btjhe->bthj', q, kg) * (HEAD_DIM_ATT ** -0.5)
    s = jnp.where(valid[None, :, None, :], s, NEG_INF)
    m = jnp.max(s, axis=-1)
    p = jnp.exp(s - m[..., None])
    den = jnp.sum(p, axis=-1)
    acc = jnp.einsum('bthj,btjhe->bthe', p, vg)
    return m, den, acc


def combine_partials(parts):
    ms = jnp.stack([pt[0] for pt in parts])
    ss = jnp.stack([pt[1] for pt in parts])
    accs = jnp.stack([pt[2] for pt in parts])
    w = jnp.exp(ms - jnp.max(ms, axis=0, keepdims=True))
    den = jnp.sum(w * ss, axis=0)
    num = jnp.sum(w[..., None] * accs, axis=0)
    return num / den[..., None]


def causal_conv(u, buf, w, b):
    S = u.shape[1]
    xp = jnp.concatenate([buf.astype(u.dtype), u], axis=1)
    y = b + xp[:, 0:S] * w[0]
    for j in range(1, CONV_WIDTH):
        y = y + xp[:, j:j + S] * w[j]
    return jax.nn.silu(y), xp[:, -(CONV_WIDTH - 1):]


def mlstm_chunkwise(q, k, v, i_pre, log_f, C0, n0, m0):
    B, H, S, DK = q.shape
    DV = v.shape[-1]
    L = MLSTM_CHUNK if S % MLSTM_CHUNK == 0 else S
    nc = S // L

    def chunks(t):
        return jnp.moveaxis(t.reshape(t.shape[:2] + (nc, L) + t.shape[3:]), 2, 0)

    causal = jnp.tril(jnp.ones((L, L), dtype=bool))

    def step(carry, xs):
        C, n, m_prev = carry
        qc, kc, vc, ic, fc = xs
        b = jnp.cumsum(fc, axis=-1)
        m_t = jnp.maximum(m_prev[..., None] + b, b + lax.cummax(ic - b, axis=2))
        inter = jnp.exp(m_prev[..., None] + b - m_t)
        dlog = b[..., :, None] - b[..., None, :] + ic[..., None, :] - m_t[..., :, None]
        dmat = jnp.exp(jnp.where(causal, dlog, NEG_INF))
        sqk = jnp.einsum('bhtd,bhsd->bhts', qc, kc) * dmat
        num = inter[..., None] * jnp.einsum('bhtd,bhde->bhte', qc, C) + jnp.einsum('bhts,bhse->bhte', sqk, vc)
        nq = inter * jnp.einsum('bhtd,bhd->bht', qc, n) + jnp.sum(sqk, axis=-1)
        den = jnp.maximum(jnp.abs(nq), jnp.exp(-m_t))
        h = num / den[..., None]
        m_last = m_t[..., -1]
        decay = jnp.exp(m_prev + b[..., -1] - m_last)
        w = jnp.exp(b[..., -1:] - b + ic - m_last[..., None])
        C_new = decay[..., None, None] * C + jnp.einsum('bhs,bhsd,bhse->bhde', w, kc, vc)
        n_new = decay[..., None] * n + jnp.einsum('bhs,bhsd->bhd', w, kc)
        return (C_new, n_new, m_last), h

    xs = (chunks(q), chunks(k), chunks(v), chunks(i_pre), chunks(log_f))
    (C, n, m), hs = lax.scan(step, (C0, n0, m0), xs)
    h = jnp.moveaxis(hs, 0, 2).reshape(B, H, S, DV)
    return h, C, n, m


def mixer_layer(x, pos, win_k, win_v, conv_buf, C0, n0, m0,
                norm_g, w_in, conv_w, conv_b, b_i, b_f, mlstm_norm_g, w_out):
    B, S, _ = x.shape
    f32 = jnp.float32
    hn = rmsnorm(x, norm_g)
    u = hn @ w_in
    offsets = [int(o) for o in np.cumsum(SPLIT_SIZES)[:-1]]
    qa, ka, va, za, qb, kb, vb, ob, zb, ib, fb = jnp.split(u, offsets, axis=-1)

    att_heads = lambda t: t.reshape(B, S, N_HEADS_ATT, HEAD_DIM_ATT).astype(f32)
    qa = rope_partial(att_heads(qa), pos)
    ka = rope_partial(att_heads(ka), pos)
    va = att_heads(va)
    if win_k is None:
        parts = [dilated_partial_prompt(qa, ka, va, dil, win // dil) for (win, dil) in DILATED_PATTERNS]
        keep = min(MAX_WINDOW, S)
        new_k, new_v = ka[:, -keep:], va[:, -keep:]
    else:
        kc = jnp.concatenate([win_k.astype(f32), ka], axis=1)
        vc = jnp.concatenate([win_v.astype(f32), va], axis=1)
        parts = [dilated_partial_sample(qa, kc, vc, dil, win // dil) for (win, dil) in DILATED_PATTERNS]
        keep = win_k.shape[1]
        new_k, new_v = kc[:, -keep:], vc[:, -keep:]
    att = combine_partials(parts).reshape(B, S, D_ATT).astype(x.dtype)
    y_a = att * jax.nn.silu(za)

    qk, new_conv = causal_conv(jnp.concatenate([qb, kb], axis=-1), conv_buf, conv_w, conv_b)
    qm, km = jnp.split(qk, 2, axis=-1)
    m_heads = lambda t: t.reshape(B, S, N_HEADS_MLSTM, HEAD_DIM_MLSTM).transpose(0, 2, 1, 3).astype(f32)
    i_pre = (ib.astype(f32) + b_i.astype(f32)).transpose(0, 2, 1)
    log_f = jax.nn.log_sigmoid(fb.astype(f32) + b_f.astype(f32)).transpose(0, 2, 1)
    h_m, C, n, m = mlstm_chunkwise(m_heads(qm), m_heads(km) * (HEAD_DIM_MLSTM ** -0.5), m_heads(vb),
                                   i_pre, log_f, C0.astype(f32), n0.astype(f32), m0.astype(f32))
    h_m = h_m.transpose(0, 2, 1, 3)
    h_m = jax.nn.sigmoid(ob.astype(f32)).reshape(B, S, N_HEADS_MLSTM, HEAD_DIM_MLSTM) * h_m
    h_m = h_m * lax.rsqrt(jnp.mean(h_m * h_m, axis=-1, keepdims=True) + EPS)
    h_m = h_m * mlstm_norm_g.astype(f32).reshape(N_HEADS_MLSTM, HEAD_DIM_MLSTM)
    y_b = h_m.reshape(B, S, D_MLSTM).astype(x.dtype) * jax.nn.silu(zb)

    y = x + jnp.concatenate([y_a, y_b], axis=-1) @ w_out
    return y, (new_k.astype(x.dtype), new_v.astype(x.dtype), new_conv, C, n, m)


def setup_inputs(seed: int = 0) -> dict:
    key = jax.random.key(seed)
    ks = jax.random.split(key, 20)
    win_buf = min(MAX_WINDOW, PAST_LEN)
    nrm = lambda k, shp: jax.random.normal(k, shp, dtype=jnp.float32)
    return {
        'x_prompt': nrm(ks[0], (BATCH, SEQ, D_MODEL)),
        'x_sample': nrm(ks[1], (DEC_BATCH, DEC_SEQ, D_MODEL)),
        'cache_win_k': nrm(ks[2], (DEPTH, DEC_BATCH, win_buf, N_HEADS_ATT, HEAD_DIM_ATT)),
        'cache_win_v': nrm(ks[3], (DEPTH, DEC_BATCH, win_buf, N_HEADS_ATT, HEAD_DIM_ATT)),
        'state_conv': nrm(ks[4], (DEPTH, DEC_BATCH, CONV_WIDTH - 1, 2 * D_MLSTM)),
        'state_C': 0.1 * nrm(ks[5], (DEPTH, DEC_BATCH, N_HEADS_MLSTM, HEAD_DIM_MLSTM, HEAD_DIM_MLSTM)),
        'state_n': 0.1 * nrm(ks[6], (DEPTH, DEC_BATCH, N_HEADS_MLSTM, HEAD_DIM_MLSTM)),
        'state_m': 0.5 * nrm(ks[7], (DEPTH, DEC_BATCH, N_HEADS_MLSTM)),
        'norm_g': 1.0 + 0.02 * nrm(ks[8], (DEPTH, D_MODEL)),
        'w_in': nrm(ks[9], (DEPTH, D_MODEL, N_IN)) * D_MODEL ** -0.5,
        'conv_w': nrm(ks[10], (DEPTH, CONV_WIDTH, 2 * D_MLSTM)) * CONV_WIDTH ** -0.5,
        'conv_b': 0.02 * nrm(ks[11], (DEPTH, 2 * D_MLSTM)),
        'b_i': 0.1 * nrm(ks[12], (DEPTH, N_HEADS_MLSTM)),
        'b_f': jnp.linspace(3.0, 6.0, N_HEADS_MLSTM, dtype=jnp.float32)[None] + 0.1 * nrm(ks[13], (DEPTH, N_HEADS_MLSTM)),
        'mlstm_norm_g': 1.0 + 0.02 * nrm(ks[14], (DEPTH, D_MLSTM)),
        'w_out': nrm(ks[15], (DEPTH, D_MIX, D_MODEL)) * D_MIX ** -0.5,
        'final_norm_g': 1.0 + 0.02 * nrm(ks[16], (D_MODEL,)),
    }


def reference(x_prompt, x_sample, cache_win_k, cache_win_v, state_conv, state_C, state_n, state_m,
              norm_g, w_in, conv_w, conv_b, b_i, b_f, mlstm_norm_g, w_out, final_norm_g):
    B, S, _ = x_prompt.shape
    DB, T, _ = x_sample.shape
    pos_p = jnp.arange(S, dtype=jnp.int32)
    pos_s = PAST_LEN + jnp.arange(T, dtype=jnp.int32)
    xp, xs = x_prompt, x_sample
    p_states, s_states = [], []
    for l in range(DEPTH):
        params = (norm_g[l], w_in[l], conv_w[l], conv_b[l], b_i[l], b_f[l], mlstm_norm_g[l], w_out[l])
        zero_conv = jnp.zeros((B, CONV_WIDTH - 1, 2 * D_MLSTM), dtype=xp.dtype)
        zero_C = jnp.zeros((B, N_HEADS_MLSTM, HEAD_DIM_MLSTM, HEAD_DIM_MLSTM), dtype=jnp.float32)
        zero_n = jnp.zeros((B, N_HEADS_MLSTM, HEAD_DIM_MLSTM), dtype=jnp.float32)
        zero_m = jnp.zeros((B, N_HEADS_MLSTM), dtype=jnp.float32)
        xp, sp = mixer_layer(xp, pos_p, None, None, zero_conv, zero_C, zero_n, zero_m, *params)
        xs, ss = mixer_layer(xs, pos_s, cache_win_k[l], cache_win_v[l], state_conv[l],
                             state_C[l], state_n[l], state_m[l], *params)
        p_states.append(sp)
        s_states.append(ss)
    y_prompt = rmsnorm(xp, final_norm_g)
    y_sample = rmsnorm(xs, final_norm_g)
    stk = lambda sts, i: jnp.stack([st[i] for st in sts])
    p_k, p_v, p_conv, p_C, p_n, p_m = [stk(p_states, i) for i in range(6)]
    s_k, s_v, s_conv, s_C, s_n, s_m = [stk(s_states, i) for i in range(6)]
    return (y_prompt, y_sample, p_k, p_v, p_conv, p_C, p_n, p_m, s_k, s_v, s_conv, s_C, s_n, s_m)
```

```cpp
#include <hip/hip_runtime.h>
#include <cstdio>
#include <cstdint>
namespace pg8 {
#define PG8_LAS __attribute__((address_space(3)))
typedef unsigned short bf16_t;
typedef short bf16x8 __attribute__((ext_vector_type(8)));
typedef float f32x4 __attribute__((ext_vector_type(4)));
typedef unsigned u32x4 __attribute__((ext_vector_type(4)));
constexpr int BM = 256, BK = 64, HALF = 128, HTB = HALF * BK * 2  , STAGE_BYTES = 8 * HTB, NXCD = 8, WGM = 8;

__host__ __device__ __forceinline__ int lds_byte(int r, int c) { const int st = (r >> 4) * 2 + (c >> 5), rr = r & 15, cc = c & 31, ob = rr * 64 + cc * 2; return st * 1024 + (ob ^ (((ob >> 9) & 1) << 5)); }
__host__ __device__ __forceinline__ void stage_rc(int b, int& R, int& C) { const int st = b / 1024, sb = b % 1024, swz = sb ^ (((sb >> 9) & 1) << 5); R = (st >> 1) * 16 + swz / 64; C = (st & 1) * 32 + (swz % 64) / 2; }
__host__ __device__ __forceinline__ int perm32(int rho) { const int n = rho >> 4, i = rho & 15; return 8 * (i >> 2) + 4 * n + (i & 3); }

struct Unit { int pm, pn; };
struct Gemm { const bf16_t* A; const bf16_t* Bt; int M, N, K; };

struct StaticOrder {
    int nM, nN, nwg, G, c;
    __host__ __device__ void init(int M, int N, int G_, int c_) { nM = M / BM; nN = N / BM; nwg = nM * nN; G = G_; c = c_; }
    __host__ __device__ bool next(int i, Unit& u) const {
        const long L = (long)i * G + c; if (L >= nwg) return false;
        int wgid = (int)L; { const int q = nwg / NXCD, r = nwg % NXCD, xcd = wgid % NXCD, off = wgid / NXCD; wgid = (xcd < r ? xcd * (q + 1) : r * (q + 1) + (xcd - r) * q) + off; }
        const int nig = WGM * nN, gid = wgid / nig, fm = gid * WGM, gsz = (nM - fm) < WGM ? (nM - fm) : WGM;
        u.pm = fm + ((wgid % nig) % gsz); u.pn = (wgid % nig) / gsz; return true;
    }
    __device__ __forceinline__ void a_ready(const Unit&) const {}
    __device__ __forceinline__ void done(const Unit&) const {}
};

__device__ __forceinline__ unsigned cvt_pk_bf16(float lo, float hi) { unsigned r; asm volatile("v_cvt_pk_bf16_f32 %0, %1, %2" : "=v"(r) : "v"(lo), "v"(hi)); return r; }

struct EpiIn {
    static constexpr bool PERM = true, AFTER_DRAIN = false;
    bf16_t* U; float* pk; float* pv; float* pconv; const float* rope; float c2;
    __device__ __forceinline__ void operator()(const f32x4 (&acc)[2][2][4][2], const Unit& u, int wr, int wc, int fr, int fq) const {
        const int grp = u.pn >> 1;
        const int cg0 = (u.pn & 1) * 256 + wc * 32 + 8 * fq;
        bf16_t* base = U + (size_t)grp * ((size_t)32768 * 512);
        const int row0 = u.pm * BM + wr * 64 + fr;
        const bool roped = (grp < 2) && ((wc & 1) == 0);
        const float sgn = (fq == 0) ? -1.f : 1.f;
        const bool f32st = (grp == 1) || (grp == 2);
        float* fbase = pk + (size_t)(grp == 2 ? 16777216 : 0);
#pragma unroll
        for (int ai = 0; ai < 2; ++ai)
#pragma unroll
            for (int m = 0; m < 4; ++m) {
                const int row = row0 + ai * HALF + m * 16, pos = row & 2047;
                f32x4 cs0 = {1.f, 1.f, 1.f, 1.f}, cs1 = cs0, sn0 = {0.f, 0.f, 0.f, 0.f}, sn1 = sn0;
                if (roped) {
                    if (fq < 2) { const f32x4* rp = (const f32x4*)(rope + (size_t)pos * 8); cs0 = rp[0]; cs1 = rp[1]; const f32x4* sp = (const f32x4*)(rope + (size_t)(2052 + pos) * 8); sn0 = sp[0] * sgn; sn1 = sp[1] * sgn; }
                }
#pragma unroll
                for (int bj = 0; bj < 2; ++bj) {
                    f32x4 v0 = acc[ai][bj][m][0], v1 = acc[ai][bj][m][1];
                    const int cg = cg0 + bj * HALF;
                    if (roped) {
                        f32x4 p0, p1;
#pragma unroll
                        for (int e = 0; e < 4; ++e) { p0[e] = __shfl_xor(v0[e], 16); p1[e] = __shfl_xor(v1[e], 16); }
                        v0 = v0 * cs0 + p0 * sn0; v1 = v1 * cs1 + p1 * sn1;
                    }
                    if (f32st) { float* o = fbase + (size_t)row * 512 + cg; *(f32x4*)o = v0; *(f32x4*)(o + 4) = v1; }
                    if ((grp == 4 || grp == 5) && pos >= 2045) { float* o = pconv + (size_t)((row >> 11) * 3 + (pos - 2045)) * 1024 + (grp - 4) * 512 + cg; *(f32x4*)o = v0; *(f32x4*)(o + 4) = v1; }
                    if (grp == 0) { v0 = v0 * c2; v1 = v1 * c2; }
                    u32x4 w; w.x = cvt_pk_bf16(v0[0], v0[1]); w.y = cvt_pk_bf16(v0[2], v0[3]); w.z = cvt_pk_bf16(v1[0], v1[1]); w.w = cvt_pk_bf16(v1[2], v1[3]);
                    *(u32x4*)(base + (size_t)row * 512 + cg) = w;
                }
            }
    }
};
struct EpiOut {
    static constexpr bool PERM = false, AFTER_DRAIN = false;
    const float* x; float* out;
    __device__ __forceinline__ void operator()(const f32x4 (&acc)[2][2][4][2], const Unit& u, int wr, int wc, int fr, int fq) const {
        const int col0 = u.pn * BM + wc * 32 + 4 * fq;
#pragma unroll
        for (int ai = 0; ai < 2; ++ai)
#pragma unroll
            for (int m = 0; m < 4; ++m) {
                const int row = u.pm * BM + ai * HALF + wr * 64 + m * 16 + fr; const size_t off = (size_t)row * 1024 + col0;
#pragma unroll
                for (int bj = 0; bj < 2; ++bj)
#pragma unroll
                    for (int n = 0; n < 2; ++n) { const f32x4 xv = *(const f32x4*)(x + off + bj * HALF + n * 16); *(f32x4*)(out + off + bj * HALF + n * 16) = xv + acc[ai][bj][m][n]; }
            }
    }
};

template <class Epi, class Sched, bool ALIGN_EPI = false, bool SP2 = false>
__device__ __forceinline__ void gemm_phase(PG8_LAS unsigned char* lds, const Gemm g, const Sched& S, const Epi& E) {
    const int tid = threadIdx.x, wid = __builtin_amdgcn_readfirstlane(tid >> 6), lane = tid & 63, wr = wid >> 2, wc = wid & 3, fr = lane & 15, fq = lane >> 4;
    const int K = g.K, nt = K / BK;
    unsigned voffA[2], voffB[2];
#pragma unroll
    for (int i = 0; i < 2; ++i) { int R, C; stage_rc(tid * 16 + i * 8192, R, C); const int Rb = Epi::PERM ? ((R & ~31) + perm32(R & 31)) : R;
        voffA[i] = (unsigned)(R * K + C) * 2u; voffB[i] = (unsigned)(Rb * K + C) * 2u; }
    const size_t kstep = (size_t)(BK * 2);
    const size_t hstep = (size_t)HALF * K * 2;
    const size_t tstep = 2 * hstep;
    const unsigned ldsw = (unsigned)wid * 1024u;
    const int aoff = lds_byte(wr * 64 + fr, fq * 8), boff = lds_byte(wc * 32 + fr, fq * 8);
#define PG8_SA(b, h) (((b) * 2 + (h)) * HTB)
#define PG8_SB(b, h) ((4 + (b) * 2 + (h)) * HTB)
#define PG8_STAGE(bufoff, gbase, voff) do { _Pragma("unroll") for (int _i = 0; _i < 2; ++_i) \
        __builtin_amdgcn_global_load_lds((const unsigned*)((const char*)(gbase) + (voff)[_i]), (PG8_LAS unsigned*)(lds + (bufoff) + ldsw + _i * 8192), 16, 0, 0); } while (0)
#define PG8_LDA(dst, b, h) do { _Pragma("unroll") for (int m = 0; m < 4; ++m) _Pragma("unroll") for (int k = 0; k < 2; ++k) dst[m][k] = *(const PG8_LAS bf16x8*)(lds + PG8_SA(b, h) + aoff + m * 2048 + k * 1024); } while (0)
#define PG8_LDB(dst, b, h) do { _Pragma("unroll") for (int n = 0; n < 2; ++n) _Pragma("unroll") for (int k = 0; k < 2; ++k) dst[n][k] = *(const PG8_LAS bf16x8*)(lds + PG8_SB(b, h) + boff + n * 2048 + k * 1024); } while (0)
#define PG8_MMA(ai, bj, At, Bt) do { __builtin_amdgcn_s_setprio(1); _Pragma("unroll") for (int m = 0; m < 4; ++m) _Pragma("unroll") for (int n = 0; n < 2; ++n) _Pragma("unroll") for (int k = 0; k < 2; ++k) \
        acc[ai][bj][m][n] = __builtin_amdgcn_mfma_f32_16x16x32_bf16(Bt[n][k], At[m][k], acc[ai][bj][m][n], 0, 0, 0); __builtin_amdgcn_s_setprio(0); } while (0)
#define PG8_WAIT_V(n) asm volatile("s_waitcnt vmcnt(" #n ")" ::: "memory")
#define PG8_WAIT_L(n) asm volatile("s_waitcnt lgkmcnt(" #n ")" ::: "memory")
#define PG8_BAR __builtin_amdgcn_s_barrier()
#define PG8_SCHED __builtin_amdgcn_sched_barrier(0)
    Unit cur, nxt; int ui = 0;
    if (!S.next(0, cur)) return;
    f32x4 acc[2][2][4][2];
#pragma unroll
    for (int a = 0; a < 2; ++a)
#pragma unroll
        for (int b = 0; b < 2; ++b)
#pragma unroll
            for (int m = 0; m < 4; ++m)
#pragma unroll
                for (int n = 0; n < 2; ++n) acc[a][b][m][n] = (f32x4){0.f, 0.f, 0.f, 0.f};
    bf16x8 At[4][2], B0[2][2], B1[2][2];
    const char* cA = (const char*)g.A + (size_t)cur.pm * tstep; const char* cB = (const char*)g.Bt + (size_t)cur.pn * tstep;
    S.a_ready(cur);
    if constexpr (SP2) {
        PG8_STAGE(PG8_SB(0, 0), cB, voffB); PG8_STAGE(PG8_SB(0, 1), cB + hstep, voffB); PG8_STAGE(PG8_SA(0, 0), cA, voffA); PG8_STAGE(PG8_SA(0, 1), cA + hstep, voffA);
        if (wr == 1) PG8_BAR;
        PG8_WAIT_V(2); PG8_BAR;
        PG8_STAGE(PG8_SB(1, 0), cB + kstep, voffB); PG8_STAGE(PG8_SA(1, 0), cA + kstep, voffA); PG8_STAGE(PG8_SB(1, 1), cB + hstep + kstep, voffB);
        PG8_WAIT_V(6); PG8_BAR;
    } else {
        PG8_STAGE(PG8_SB(0, 0), cB, voffB); PG8_STAGE(PG8_SA(0, 0), cA, voffA); PG8_STAGE(PG8_SB(0, 1), cB + hstep, voffB); PG8_STAGE(PG8_SA(0, 1), cA + hstep, voffA);
        if (wr == 1) PG8_BAR;
        PG8_WAIT_V(4); PG8_BAR;
        PG8_STAGE(PG8_SB(1, 0), cB + kstep, voffB); PG8_STAGE(PG8_SA(1, 0), cA + kstep, voffA); PG8_STAGE(PG8_SB(1, 1), cB + hstep + kstep, voffB);
        PG8_WAIT_V(6); PG8_BAR;
    }
    for (;;) {
        const bool has_next = S.next(ui + 1, nxt);
        const char* nA = has_next ? (const char*)g.A + (size_t)nxt.pm * tstep : cA; const char* nB = has_next ? (const char*)g.Bt + (size_t)nxt.pn * tstep : cB;
        for (int t = 0; t < nt; t += 2) {
            const bool last = (t == nt - 2);
            const char* a1 = cA + (size_t)(t + 1) * kstep;
            const char* a2 = last ? nA : cA + (size_t)(t + 2) * kstep; const char* b2 = last ? nB : cB + (size_t)(t + 2) * kstep;
            const char* a3 = a2 + kstep; const char* b3 = b2 + kstep;
            if (last && has_next) S.a_ready(nxt);
            if constexpr (SP2) {
            PG8_LDB(B0, 0, 0); PG8_LDB(B1, 0, 1); PG8_SCHED; PG8_LDA(At, 0, 0); PG8_STAGE(PG8_SA(1, 1), a1 + hstep, voffA);
            PG8_WAIT_V(8); PG8_WAIT_L(0); PG8_BAR; PG8_MMA(0, 0, At, B0); PG8_MMA(0, 1, At, B1); PG8_BAR; PG8_SCHED;
            PG8_LDA(At, 0, 1); PG8_STAGE(PG8_SB(0, 0), b2, voffB); PG8_STAGE(PG8_SB(0, 1), b2 + hstep, voffB); PG8_STAGE(PG8_SA(0, 0), a2, voffA);
            PG8_WAIT_V(8); PG8_WAIT_L(0); PG8_BAR; PG8_MMA(1, 0, At, B0); PG8_MMA(1, 1, At, B1); PG8_BAR; PG8_SCHED;
            PG8_LDB(B0, 1, 0); PG8_LDB(B1, 1, 1); PG8_SCHED; PG8_LDA(At, 1, 0); PG8_STAGE(PG8_SA(0, 1), a2 + hstep, voffA);
            PG8_WAIT_V(8); PG8_WAIT_L(0); PG8_BAR; PG8_MMA(0, 0, At, B0); PG8_MMA(0, 1, At, B1); PG8_BAR; PG8_SCHED;
            PG8_LDA(At, 1, 1); PG8_STAGE(PG8_SB(1, 0), b3, voffB); PG8_STAGE(PG8_SB(1, 1), b3 + hstep, voffB); PG8_STAGE(PG8_SA(1, 0), a3, voffA);
            PG8_WAIT_V(8); PG8_WAIT_L(0); PG8_BAR; PG8_MMA(1, 0, At, B0); PG8_MMA(1, 1, At, B1); PG8_BAR; PG8_SCHED;
            } else {
            PG8_LDB(B0, 0, 0); PG8_SCHED; PG8_LDA(At, 0, 0); PG8_STAGE(PG8_SA(1, 1), a1 + hstep, voffA);
            PG8_WAIT_L(8); PG8_BAR; PG8_WAIT_L(0); PG8_MMA(0, 0, At, B0); PG8_BAR; PG8_SCHED;
            PG8_LDB(B1, 0, 1); PG8_STAGE(PG8_SB(0, 0), b2, voffB);
            PG8_BAR; PG8_WAIT_L(0); PG8_MMA(0, 1, At, B1); PG8_BAR;
            PG8_LDA(At, 0, 1); PG8_STAGE(PG8_SA(0, 0), a2, voffA);
            PG8_BAR; PG8_WAIT_L(0); PG8_MMA(1, 0, At, B0); PG8_BAR; PG8_SCHED;
            PG8_STAGE(PG8_SB(0, 1), b2 + hstep, voffB);
            PG8_WAIT_V(6); PG8_BAR; PG8_MMA(1, 1, At, B1); PG8_BAR;
            PG8_LDB(B0, 1, 0); PG8_SCHED; PG8_LDA(At, 1, 0); PG8_STAGE(PG8_SA(0, 1), a2 + hstep, voffA);
            PG8_WAIT_L(8); PG8_BAR; PG8_WAIT_L(0); PG8_MMA(0, 0, At, B0); PG8_BAR; PG8_SCHED;
            PG8_LDB(B1, 1, 1); PG8_STAGE(PG8_SB(1, 0), b3, voffB);
            PG8_BAR; PG8_WAIT_L(0); PG8_MMA(0, 1, At, B1); PG8_BAR;
            PG8_LDA(At, 1, 1); PG8_STAGE(PG8_SA(1, 0), a3, voffA);
            PG8_BAR; PG8_WAIT_L(0); PG8_MMA(1, 0, At, B0); PG8_BAR; PG8_SCHED;
            PG8_STAGE(PG8_SB(1, 1), b3 + hstep, voffB);
            PG8_WAIT_V(6); PG8_BAR; PG8_MMA(1, 1, At, B1); PG8_BAR;
            }
        }
        if constexpr (ALIGN_EPI) { if (wr == 0) PG8_BAR; }
        if constexpr (!Epi::AFTER_DRAIN) { E(acc, cur, wr, wc, fr, fq); S.done(cur); }
        if (!has_next) break;
#pragma unroll
        for (int a = 0; a < 2; ++a)
#pragma unroll
            for (int b = 0; b < 2; ++b)
#pragma unroll
                for (int m = 0; m < 4; ++m)
#pragma unroll
                    for (int n = 0; n < 2; ++n) acc[a][b][m][n] = (f32x4){0.f, 0.f, 0.f, 0.f};
        cur = nxt; cA = nA; cB = nB; ++ui;
        if constexpr (ALIGN_EPI) { if (wr == 1) PG8_BAR; }
    }
    PG8_WAIT_V(0);
    if constexpr (!ALIGN_EPI) { if (wr == 0) PG8_BAR; }
    PG8_BAR;
    if constexpr (Epi::AFTER_DRAIN) { E.fused(acc, cur, wr, wc, fr, fq, lds, wid, lane); S.done(cur); }
#undef PG8_SA
#undef PG8_SB
#undef PG8_STAGE
#undef PG8_LDA
#undef PG8_LDB
#undef PG8_MMA
#undef PG8_WAIT_V
#undef PG8_WAIT_L
#undef PG8_BAR
#undef PG8_SCHED
}
}

#define GAS __attribute__((address_space(1)))
#define LAS __attribute__((address_space(3)))
typedef unsigned short bf16;
typedef unsigned v4u __attribute__((ext_vector_type(4)));
typedef float f32x4 __attribute__((ext_vector_type(4)));
typedef short bf16x8 __attribute__((ext_vector_type(8)));
typedef GAS unsigned gu32;
typedef GAS unsigned long long gu64;
#define RLX_AGENT __ATOMIC_RELAXED, __HIP_MEMORY_SCOPE_AGENT
#define LDS_WAIT() asm volatile("s_waitcnt lgkmcnt(0)" ::: "memory")
#define VM_WAIT() asm volatile("s_waitcnt vmcnt(0)" ::: "memory")
__device__ __forceinline__ unsigned long long rt() { return __builtin_amdgcn_s_memrealtime(); }
__device__ __forceinline__ unsigned f2bf(float f) { unsigned u = __builtin_bit_cast(unsigned, f); return (u + 0x7fffu + ((u >> 16) & 1u)) >> 16; }
__device__ __forceinline__ unsigned pk2(float lo, float hi) { return f2bf(lo) | (f2bf(hi) << 16); }

#define XB_TMO      128
#define XB_XCNT(j)  (256  + 64 * (j))
#define XB_XSUB(j)  (1280 + 64 * (j))
#define XB_XGEN(j)  (2304 + 64 * (j))
#define XB_TOP      3328
#define XB_TOPGEN   3392
#define XCD_BAR_WORDS 3456
#define XB_SPIN_CAP (1u << 18)

__device__ __forceinline__ unsigned xb_ld(unsigned* p)              { return __hip_atomic_load(p, __ATOMIC_RELAXED, __HIP_MEMORY_SCOPE_AGENT); }
__device__ __forceinline__ unsigned xb_add(unsigned* p, unsigned v) { return __hip_atomic_fetch_add(p, v, __ATOMIC_RELAXED, __HIP_MEMORY_SCOPE_AGENT); }
__device__ __forceinline__ unsigned xb_xcc_id() { return (unsigned)__builtin_amdgcn_s_getreg((3 << 11) | 20) & 0xFu; }
#define XB_SPIN(cond, bar) do { unsigned _sp = 0; while (cond) { __builtin_amdgcn_s_sleep(1); \
    if ((++_sp & 255u) == 0u) { if (xb_ld(&(bar)[XB_TMO])) break; if (_sp > XB_SPIN_CAP) { atomicAdd(&(bar)[XB_TMO], 1u); break; } } } } while (0)

struct XcdBarrier {
    unsigned* bar; unsigned x;
    volatile LAS unsigned* st;
};

__device__ __forceinline__ XcdBarrier xcd_barrier_post(unsigned* bar, volatile LAS unsigned* st) {
    XcdBarrier b; b.bar = bar; b.x = xb_xcc_id(); b.st = st;
    if (threadIdx.x == 0) (void)xb_add(&bar[XB_XCNT(b.x)], 1u);
    return b;
}
__device__ __forceinline__ void xcd_barrier_complete(unsigned* bar, unsigned x, unsigned& nloc, unsigned& nx) {
    const unsigned G = gridDim.x * gridDim.y * gridDim.z;
    unsigned sum, cnt, mine, sp = 0u;
    for (;;) {
        sum = 0u; cnt = 0u; mine = 0u;
#pragma unroll
        for (unsigned j = 0; j < 16; ++j) { const unsigned c = xb_ld(&bar[XB_XCNT(j)]); sum += c; cnt += (c > 0u) ? 1u : 0u; mine = (j == x) ? c : mine; }
        if (sum == G) break;
        __builtin_amdgcn_s_sleep(1);
        if ((++sp & 255u) == 0u) { if (xb_ld(&bar[XB_TMO])) break; if (sp > XB_SPIN_CAP) { atomicAdd(&bar[XB_TMO], 1u); break; } }
    }
    nloc = mine > 0u ? mine : 1u; nx = cnt > 0u ? cnt : 1u;
}

__device__ __forceinline__ void xcd_barrier(const XcdBarrier& b) {
    asm volatile("s_waitcnt vmcnt(0)" ::: "memory");
    __syncthreads();
    if (threadIdx.x == 0) {
        unsigned* bar = b.bar;
        __builtin_amdgcn_s_waitcnt(0);
        unsigned nloc = b.st[0], nx = b.st[1];
        if (nloc == 0u) { xcd_barrier_complete(bar, b.x, nloc, nx); b.st[0] = nloc; b.st[1] = nx; }
        const unsigned old = xb_add(&bar[XB_XSUB(b.x)], 1u);
        const unsigned gen = old / nloc;
        if (old + 1u == (gen + 1u) * nloc) {
            __builtin_amdgcn_fence(__ATOMIC_RELEASE, "agent");
            asm volatile("s_waitcnt vmcnt(0)" ::: "memory");
            const unsigned og = xb_add(&bar[XB_TOP], 1u);
            const unsigned tg = og / nx;
            if (og + 1u == (tg + 1u) * nx) xb_add(&bar[XB_TOPGEN], 1u);
            else XB_SPIN(xb_ld(&bar[XB_TOPGEN]) == tg, bar);
            __builtin_amdgcn_fence(__ATOMIC_ACQUIRE, "agent");
            xb_add(&bar[XB_XGEN(b.x)], 1u);
            asm volatile("s_waitcnt vmcnt(0)" ::: "memory");
        } else {
            XB_SPIN(xb_ld(&bar[XB_XGEN(b.x)]) == gen, bar);
            __builtin_amdgcn_fence(__ATOMIC_ACQUIRE, "agent");
            asm volatile("s_waitcnt vmcnt(0)" ::: "memory");
        }
    }
    __syncthreads();
}

constexpr int NWAVES = 8;
#ifndef MK_N_LAUNCHES
#define MK_N_LAUNCHES 7
#endif
constexpr int N_PHASES = 7;
constexpr int NB = 16, SEQ = 2048, DM = 1024, MTOK = NB * SEQ, NSB = 32, NST = 4, MS = NSB * NST, WINB = 2048;
constexpr int NIN = 4616, NG = 4608;
constexpr float EPS = 1e-6f;
constexpr float C2 = 0.125f * 1.4426950408889634f;
constexpr float KSCALE = 0.08838834764831845f;
constexpr size_t MiB = 1u << 20;
constexpr size_t WS_CTL = 0, CTL_ZERO_BYTES = 1 * MiB;
constexpr size_t WS_WTIN = 2 * MiB, WS_WTOUT = 12 * MiB, WS_ROPE = 14 * MiB, WS_GATES = 15 * MiB, WS_ROWSS = 17 * MiB;
constexpr size_t WS_HNS = 18 * MiB, WS_US = 19 * MiB, WS_YMS = 23 * MiB, WS_YPS = 24 * MiB;
constexpr size_t WS_CHA = 26 * MiB, WS_DN = 27 * MiB, WS_NPREV = 28 * MiB;
constexpr size_t WS_HN = 32 * MiB, WS_U = 96 * MiB, WS_PO16 = 384 * MiB, WS_PO4 = 416 * MiB, WS_PL = 448 * MiB, WS_END = 450 * MiB;
constexpr size_t GRP = (size_t)MTOK * 512;
constexpr size_t O_YP = 0, O_YS = 33554432, O_PK = 33685504, O_PV = 50462720, O_PCONV = 67239936, O_PC = 67289088, O_PN = 68337664, O_PM = 68345856,
                 O_SK = 68345920, O_SV = 101900352, O_SCONV = 135454784, O_SC = 135553088, O_SN = 137650240, O_SM = 137666624, O_END = 137666752;
constexpr int CW_BAR = 4096;
constexpr int RING_OFF = 0, RING_BYTES = 131072, LDSCTL_OFF = RING_BYTES, MISC_OFF = LDSCTL_OFF + 320, XTRA_OFF = RING_BYTES + 1024, LDS_BYTES = 147456;

typedef short v4i16_t __attribute__((ext_vector_type(4)));
typedef unsigned u32x2 __attribute__((ext_vector_type(2)));
__device__ __forceinline__ float bf2f(unsigned short h) { return __builtin_bit_cast(float, (unsigned)h << 16); }
__device__ __forceinline__ float bflo(unsigned w) { return __builtin_bit_cast(float, w << 16); }
__device__ __forceinline__ float bfhi(unsigned w) { return __builtin_bit_cast(float, w & 0xffff0000u); }
__device__ __forceinline__ float wave_sum(float v) {
#pragma unroll
    for (int o = 1; o < 64; o <<= 1) v += __shfl_xor(v, o);
    return v;
}
__device__ __forceinline__ float wave_max(float v) {
#pragma unroll
    for (int o = 1; o < 64; o <<= 1) v = fmaxf(v, __shfl_xor(v, o));
    return v;
}
__device__ __forceinline__ float siluf(float z) { return z / (1.f + __expf(-z)); }
__device__ __forceinline__ float sigmf(float z) { return 1.f / (1.f + __expf(-z)); }
__device__ __forceinline__ v4i16_t tr16(LAS const unsigned char* p) { return __builtin_amdgcn_ds_read_tr16_b64_v4i16((LAS v4i16_t*)p); }
__device__ __forceinline__ bf16x8 cat44(v4i16_t a, v4i16_t b) { return (bf16x8){a[0], a[1], a[2], a[3], b[0], b[1], b[2], b[3]}; }
__device__ __forceinline__ int off256(int r, int ch) { return 256 * r + 16 * (ch ^ (((r & 3) << 2) | ((r >> 2) & 3))); }

struct Frame {
    LAS unsigned char* lds;
    volatile LAS unsigned* MISC;
    unsigned* ctl;
    int tid, lane, wave, vcu, G;
    const float *xp, *xs, *ck, *cv, *sconv, *sC, *sn, *sm, *norm_g, *w_in, *conv_w, *conv_b, *b_i, *b_f, *mnorm_g, *w_out, *fnorm_g;
    float* out; unsigned char* ws;
    bf16 *wt_in, *wt_out, *hn, *U, *po16, *po4, *hns, *yms;
    float *rope, *gates, *rowss, *us, *yps, *chA, *chB, *mprev, *dn, *nprev, *pl;
    float* dC; bf16* cprev;
};

__device__ __forceinline__ void p0_transpose_item(const float* W, int K, int ld, int ncols, bf16* WT, LAS float* scr, int item, int lane) {
    const int nblk = ncols / 32, kb = item / nblk, nb = item % nblk, k0 = 64 * kb, n0 = 32 * nb;
#pragma unroll 8
    for (int i = 0; i < 32; ++i) { const int kk = 2 * i + (lane >> 5); scr[kk * 33 + (lane & 31)] = W[(size_t)(k0 + kk) * ld + n0 + (lane & 31)]; }
    LDS_WAIT(); asm volatile("" ::: "memory");
    const int c = lane & 7;
#pragma unroll
    for (int j = 0; j < 4; ++j) { const int n = (lane >> 3) + 8 * j; const LAS float* s = scr + (8 * c) * 33 + n;
        v4u o; o.x = pk2(s[0 * 33], s[1 * 33]); o.y = pk2(s[2 * 33], s[3 * 33]); o.z = pk2(s[4 * 33], s[5 * 33]); o.w = pk2(s[6 * 33], s[7 * 33]);
        *(GAS v4u*)(WT + (size_t)(n0 + n) * K + k0 + 8 * c) = o; }
    LDS_WAIT(); asm volatile("" ::: "memory");
}
__device__ __forceinline__ void sincos_d(float ang, float& s, float& c) {
    const double x = (double)ang, k = __builtin_rint(x * 0.63661977236758134308), r = __builtin_fma(-k, 1.57079632679489661923, x), r2 = r * r;
    double sp = -7.6471637318198164759e-13; sp = sp * r2 + 1.6059043836821614599e-10; sp = sp * r2 - 2.5052108385441718775e-8; sp = sp * r2 + 2.7557319223985890653e-6;
    sp = sp * r2 - 1.9841269841269841270e-4; sp = sp * r2 + 8.3333333333333333333e-3; sp = sp * r2 - 1.6666666666666666667e-1; sp = sp * r2 * r + r;
    double cp = 4.7794773323873852974e-14; cp = cp * r2 - 1.1470745597729724714e-11; cp = cp * r2 + 2.0876756987868098979e-9; cp = cp * r2 - 2.7557319223985890653e-7;
    cp = cp * r2 + 2.4801587301587301587e-5; cp = cp * r2 - 1.3888888888888888889e-3; cp = cp * r2 + 4.1666666666666666667e-2; cp = cp * r2 - 0.5; cp = cp * r2 + 1.0;
    const int q = (int)k & 3;
    const double ss = (q & 1) ? cp : sp, cc = (q & 1) ? sp : cp;
    s = (float)((q & 2) ? -ss : ss); c = (float)(((q + 1) & 2) ? -cc : cc);
}
__device__ __forceinline__ void p0_row(Frame& F, const float* xrow, bf16* orow, float* grow, const f32x4 (&g)[4], LAS const float* gw) {
    const GAS f32x4* xr = (const GAS f32x4*)xrow + F.lane;
    f32x4 v[4]; float s = 0.f;
#pragma unroll
    for (int j = 0; j < 4; ++j) { v[j] = xr[64 * j]; s += (v[j].x * v[j].x + v[j].y * v[j].y) + (v[j].z * v[j].z + v[j].w * v[j].w); }
    const float rstd = 1.f / sqrtf(wave_sum(s) * (1.f / 1024.f) + EPS);
    f32x4 d0 = {0.f, 0.f, 0.f, 0.f}, d1 = d0;
#pragma unroll
    for (int j = 0; j < 4; ++j)
#pragma unroll
        for (int e = 0; e < 4; ++e) { const LAS f32x4* wp = (const LAS f32x4*)gw + ((j * 4 + e) * 2) * 64 + F.lane; const float x = v[j][e]; d0 += wp[0] * x; d1 += wp[64] * x; }
    float dd[8] = {d0.x, d0.y, d0.z, d0.w, d1.x, d1.y, d1.z, d1.w};
#pragma unroll
    for (int c = 0; c < 8; ++c) dd[c] = wave_sum(dd[c]);
    float val = dd[0];
#pragma unroll
    for (int c = 1; c < 8; ++c) val = (F.lane == c) ? dd[c] : val;
    if (F.lane < 8) {
        float z = val * rstd + ((F.lane < 4) ? F.b_i[F.lane] : F.b_f[F.lane - 4]);
        if (F.lane >= 4) z = fminf(z, 0.f) - log1pf(__expf(-fabsf(z)));
        grow[F.lane] = z;
    }
    GAS unsigned long long* o8 = (GAS unsigned long long*)orow + F.lane;
#pragma unroll
    for (int j = 0; j < 4; ++j) { const f32x4 o = v[j] * g[j] * rstd; o8[64 * j] = (unsigned long long)pk2(o.x, o.y) | ((unsigned long long)pk2(o.z, o.w) << 32); }
}
__device__ __forceinline__ void p0_prologue(Frame& F) {
    LAS float* scr = (LAS float*)(F.lds + RING_OFF + F.wave * 16384);
    const int gwv = F.vcu * NWAVES + F.wave, NGW = F.G * NWAVES;
    constexpr int I_IN = (DM / 64) * (NG / 32), I_OUT = (DM / 64) * (DM / 32);
    for (int it = gwv; it < I_IN + I_OUT; it += NGW) {
        if (it < I_IN) p0_transpose_item(F.w_in, DM, NIN, NG, F.wt_in, scr, it, F.lane);
        else p0_transpose_item(F.w_out, DM, DM, DM, F.wt_out, scr, it - I_IN, F.lane);
    }
    __syncthreads();
    LAS float* gw = (LAS float*)(F.lds + RING_OFF);
    for (int idx = F.tid; idx < 8192; idx += NWAVES * 64) { const int k = idx >> 3, c = idx & 7, j = k >> 8, l = (k & 255) >> 2, e = k & 3;
        gw[((((j * 4 + e) * 2 + (c >> 2)) * 64 + l) * 4) + (c & 3)] = F.w_in[(size_t)k * NIN + NG + c] * F.norm_g[k]; }
    __syncthreads();
    f32x4 g[4];
#pragma unroll
    for (int j = 0; j < 4; ++j) g[j] = ((const f32x4*)F.norm_g)[F.lane + 64 * j];
    for (int m = gwv; m < MTOK + MS; m += NGW) {
        if (m < MTOK) p0_row(F, F.xp + (size_t)m * DM, F.hn + (size_t)m * DM, F.gates + (size_t)m * 8, g, gw);
        else p0_row(F, F.xs + (size_t)(m - MTOK) * DM, F.hns + (size_t)(m - MTOK) * DM, F.gates + (size_t)m * 8, g, gw);
    }
    const int gt = F.vcu * (NWAVES * 64) + F.tid, NT = F.G * NWAVES * 64;
    for (int idx = gt; idx < 2052 * 8; idx += NT) { const int pi = idx >> 3, d = idx & 7; const int pos = pi < 2048 ? pi : 16384 + (pi - 2048);
        const float inv = powf(500000.0f, -(float)d * 0.125f); float s, c; sincos_d((float)pos * inv, s, c); F.rope[idx] = c; F.rope[2052 * 8 + idx] = s; }
    for (int idx = gt; idx < MTOK + MS; idx += NT) F.rowss[idx] = 0.f;
    constexpr int PER = 2044 * 512 / 4;
    for (int cb = 0; cb < 2 * NSB; ++cb) {
        const float* src = (cb < NSB ? F.ck : F.cv) + (size_t)(cb & (NSB - 1)) * WINB * 512 + 4 * 512;
        float* dst = F.out + (cb < NSB ? O_SK : O_SV) + (size_t)(cb & (NSB - 1)) * WINB * 512;
        for (int e = gt; e < PER; e += NT) { const f32x4 t = __builtin_nontemporal_load((const f32x4*)src + e); __builtin_nontemporal_store(t, (f32x4*)dst + e); }
    }
}

__device__ __forceinline__ void small_gemm(Frame& F, const bf16* A, const bf16* Bt, int N, int K, float* O, int ldo, const float* add) {
    const int fr = F.lane & 15, fq = F.lane >> 4;
    for (int ct = F.vcu; ct < N / 16; ct += F.G) {
        const bf16* ap = A + (size_t)(16 * F.wave + fr) * K + 8 * fq; const bf16* bp = Bt + (size_t)(16 * ct + fr) * K + 8 * fq;
        f32x4 acc = {0.f, 0.f, 0.f, 0.f};
#pragma unroll 8
        for (int ks = 0; ks < K / 32; ++ks) { const bf16x8 a = *(const bf16x8*)(ap + 32 * ks), b = *(const bf16x8*)(bp + 32 * ks); acc = __builtin_amdgcn_mfma_f32_16x16x32_bf16(a, b, acc, 0, 0, 0); }
#pragma unroll
        for (int i = 0; i < 4; ++i) { const size_t o = (size_t)(16 * F.wave + 4 * fq + i) * ldo + 16 * ct + fr; O[o] = acc[i] + (add ? add[o] : 0.f); }
    }
}

struct AttU { int dl, b, h, r, c; };
__device__ __forceinline__ AttU att_decode(int pat_dl, int u) {
    AttU a; a.dl = pat_dl; const int bh = u >> 4, j = u & 15, lb = 4 - pat_dl;
    a.b = bh >> 3; a.h = bh & 7; a.c = j & ((1 << lb) - 1); a.r = j >> lb; return a;
}
__device__ __forceinline__ void att_issue(Frame& F, const AttU& u, int buf) {
    const bf16* KA = F.U + 1 * GRP; const bf16* VA = F.U + 2 * GRP;
#pragma unroll
    for (int j = 0; j < 4; ++j) {
        const int t = 4 * F.wave + j, row = 8 * t + (F.lane >> 3);
        int sp = 128 * u.c - 128 + row; if (sp < 0) sp += 128;
        const int tok = (sp << u.dl) + u.r, sc = (F.lane & 7) ^ (F.lane >> 3);
        const size_t go = ((size_t)(u.b * SEQ + tok) * 512 + u.h * 64 + sc * 8);
        __builtin_amdgcn_global_load_lds((const unsigned*)(KA + go), (LAS unsigned*)(F.lds + buf * 65536 + t * 1024), 16, 0, 0);
        __builtin_amdgcn_global_load_lds((const unsigned*)(VA + go), (LAS unsigned*)(F.lds + buf * 65536 + 32768 + t * 1024), 16, 0, 0);
    }
}
template <int MODE>
__device__ __forceinline__ void att_compute(Frame& F, const AttU& u, int buf, bf16x8 q0, bf16x8 q1) {
    const int w = F.wave, fr = F.lane & 15, fq = F.lane >> 4;
    LAS const unsigned char* Kb = F.lds + buf * 65536; LAS const unsigned char* Vb = Kb + 32768;
    f32x4 s[9];
#pragma unroll
    for (int g = 0; g < 9; ++g) {
        const int rl = 16 * w + 16 * g + fr; LAS const unsigned char* kp = Kb + rl * 128; const int sw = rl & 7;
        const bf16x8 a0 = *(LAS const bf16x8*)(kp + ((fq ^ sw) << 4)), a1 = *(LAS const bf16x8*)(kp + (((4 + fq) ^ sw) << 4));
        f32x4 z = {0.f, 0.f, 0.f, 0.f};
        z = __builtin_amdgcn_mfma_f32_16x16x32_bf16(a0, q0, z, 0, 0, 0);
        s[g] = __builtin_amdgcn_mfma_f32_16x16x32_bf16(a1, q1, z, 0, 0, 0);
    }
    const float NEG = -1e30f; const bool c0 = (u.c == 0);
    float mx = NEG;
#pragma unroll
    for (int g = 0; g < 9; ++g)
#pragma unroll
        for (int i = 0; i < 4; ++i) {
            bool ok = true;
            if (g == 0) ok = (fr <= 4 * fq + i);
            if (g == 8) ok = (4 * fq + i <= fr);
            if (c0 && (w + g < 8)) ok = false;
            s[g][i] = ok ? s[g][i] : NEG; mx = fmaxf(mx, s[g][i]);
        }
    mx = fmaxf(mx, __shfl_xor(mx, 16)); mx = fmaxf(mx, __shfl_xor(mx, 32));
    float sum = 0.f;
#pragma unroll
    for (int g = 0; g < 9; ++g)
#pragma unroll
        for (int i = 0; i < 4; ++i) { s[g][i] = __builtin_amdgcn_exp2f(s[g][i] - mx); sum += s[g][i]; }
    sum += __shfl_xor(sum, 16); sum += __shfl_xor(sum, 32);
    f32x4 o[4];
#pragma unroll
    for (int n = 0; n < 4; ++n) o[n] = (f32x4){0.f, 0.f, 0.f, 0.f};
#pragma unroll
    for (int st = 0; st < 5; ++st) {
        bf16x8 pf;
        { const f32x4 pa = s[2 * st]; const f32x4 pb = (st < 4) ? s[2 * st + 1 < 9 ? 2 * st + 1 : 8] : (f32x4){0.f, 0.f, 0.f, 0.f};
          const unsigned w0 = pk2(pa[0], pa[1]), w1 = pk2(pa[2], pa[3]), w2 = pk2(pb[0], pb[1]), w3 = pk2(pb[2], pb[3]);
          pf = __builtin_bit_cast(bf16x8, (v4u){w0, w1, w2, w3}); }
#pragma unroll
        for (int n = 0; n < 4; ++n) {
            const int r0 = 16 * w + 32 * st + 4 * fq + (fr >> 2), r1 = (st < 4) ? r0 + 16 : r0;
            const int ch = 2 * n + ((fr & 3) >> 1), bo = 8 * (fr & 1);
            const v4i16_t t0 = tr16(Vb + r0 * 128 + ((ch ^ (r0 & 7)) << 4) + bo), t1 = tr16(Vb + r1 * 128 + ((ch ^ (r1 & 7)) << 4) + bo);
            o[n] = __builtin_amdgcn_mfma_f32_16x16x32_bf16(cat44(t0, t1), pf, o[n], 0, 0, 0);
        }
    }
    const float inv = 1.f / sum;
    const int tok = ((128 * u.c + 16 * w + fr) << u.dl) + u.r; const size_t rowi = (size_t)(u.b * SEQ + tok);
    if (MODE == 0) {
        bf16* PO = (u.dl == 4) ? F.po16 : F.po4; float* PL = F.pl + (u.dl == 4 ? 0 : (size_t)MTOK * 8);
#pragma unroll
        for (int n = 0; n < 4; ++n) { u32x2 v; v.x = pk2(o[n][0] * inv, o[n][1] * inv); v.y = pk2(o[n][2] * inv, o[n][3] * inv); *(u32x2*)(PO + rowi * 512 + u.h * 64 + 16 * n + 4 * fq) = v; }
        if (fq == 0) PL[rowi * 8 + u.h] = mx + __builtin_amdgcn_logf(sum);
    } else {
        const float la = F.pl[rowi * 8 + u.h], lb = F.pl[(size_t)MTOK * 8 + rowi * 8 + u.h], lc = mx + __builtin_amdgcn_logf(sum);
        const float M = fmaxf(fmaxf(la, lb), lc); const float wa = __builtin_amdgcn_exp2f(la - M), wb = __builtin_amdgcn_exp2f(lb - M), wc = __builtin_amdgcn_exp2f(lc - M) * inv;
        const float rd = 1.f / (wa + wb + wc * sum);
        const bf16* ZA = F.U + 3 * GRP;
#pragma unroll
        for (int n = 0; n < 4; ++n) {
            const size_t eo = rowi * 512 + u.h * 64 + 16 * n + 4 * fq;
            const u32x2 pa = *(const u32x2*)(F.po16 + eo), pb = *(const u32x2*)(F.po4 + eo), zz = *(const u32x2*)(ZA + eo);
            const float y0 = (wa * bflo(pa.x) + wb * bflo(pb.x) + wc * o[n][0]) * rd * siluf(bflo(zz.x));
            const float y1 = (wa * bfhi(pa.x) + wb * bfhi(pb.x) + wc * o[n][1]) * rd * siluf(bfhi(zz.x));
            const float y2 = (wa * bflo(pa.y) + wb * bflo(pb.y) + wc * o[n][2]) * rd * siluf(bflo(zz.y));
            const float y3 = (wa * bfhi(pa.y) + wb * bfhi(pb.y) + wc * o[n][3]) * rd * siluf(bfhi(zz.y));
            u32x2 v; v.x = pk2(y0, y1); v.y = pk2(y2, y3); *(u32x2*)(F.hn + rowi * 1024 + u.h * 64 + 16 * n + 4 * fq) = v;
        }
    }
}
template <int MODE>
__device__ __forceinline__ void att_phase(Frame& F, int dl0, int dl1, int ntot) {
    const bf16* QA = F.U;
    const int fr = F.lane & 15, fq = F.lane >> 4;
    int i = F.vcu; if (i >= ntot) return;
    AttU cur = att_decode(i < 2048 ? dl0 : dl1, i & 2047);
    att_issue(F, cur, 0);
    bf16x8 q0, q1;
    { const int tok = ((128 * cur.c + 16 * F.wave + fr) << cur.dl) + cur.r; const bf16* qp = QA + (size_t)(cur.b * SEQ + tok) * 512 + cur.h * 64 + 8 * fq; q0 = *(const bf16x8*)qp; q1 = *(const bf16x8*)(qp + 32); }
    int buf = 0;
    for (;;) {
        VM_WAIT(); __syncthreads();
        const int ni = i + F.G; const bool has_next = ni < ntot;
        AttU nxt = cur; bf16x8 n0 = q0, n1 = q1;
        if (has_next) {
            nxt = att_decode(ni < 2048 ? dl0 : dl1, ni & 2047);
            att_issue(F, nxt, buf ^ 1);
            const int tok = ((128 * nxt.c + 16 * F.wave + fr) << nxt.dl) + nxt.r; const bf16* qp = QA + (size_t)(nxt.b * SEQ + tok) * 512 + nxt.h * 64 + 8 * fq; n0 = *(const bf16x8*)qp; n1 = *(const bf16x8*)(qp + 32);
        }
        att_compute<MODE>(F, cur, buf, q0, q1);
        if (!has_next) break;
        cur = nxt; q0 = n0; q1 = n1; i = ni; buf ^= 1;
    }
    VM_WAIT(); __syncthreads();
}

template <bool WROW>
__device__ __forceinline__ void fill_conv_tile(Frame& F, LAS unsigned char* tile, const bf16* Gm, int b, int t0, int hh, int cbase, float scale, const LAS float* wrow) {
    const int ch16 = F.tid & 15, chan = cbase + hh * 128 + 8 * ch16;
    float cw[4][8], cb[8];
#pragma unroll
    for (int j = 0; j < 4; ++j) { const f32x4 a = *(const f32x4*)(F.conv_w + j * 1024 + chan), c = *(const f32x4*)(F.conv_w + j * 1024 + chan + 4);
        cw[j][0] = a.x; cw[j][1] = a.y; cw[j][2] = a.z; cw[j][3] = a.w; cw[j][4] = c.x; cw[j][5] = c.y; cw[j][6] = c.z; cw[j][7] = c.w; }
    { const f32x4 a = *(const f32x4*)(F.conv_b + chan), c = *(const f32x4*)(F.conv_b + chan + 4); cb[0] = a.x; cb[1] = a.y; cb[2] = a.z; cb[3] = a.w; cb[4] = c.x; cb[5] = c.y; cb[6] = c.z; cb[7] = c.w; }
#pragma unroll
    for (int it = 0; it < 4; ++it) {
        const int t = (F.tid >> 4) + 32 * it;
        float y[8];
#pragma unroll
        for (int e = 0; e < 8; ++e) y[e] = cb[e];
#pragma unroll
        for (int j = 0; j < 4; ++j) {
            const int tt = t0 + t - 3 + j;
            if (tt >= 0) {
                const v4u raw = *(const v4u*)(Gm + ((size_t)(b * SEQ + tt) * 512 + hh * 128 + 8 * ch16));
                y[0] += cw[j][0] * bflo(raw.x); y[1] += cw[j][1] * bfhi(raw.x); y[2] += cw[j][2] * bflo(raw.y); y[3] += cw[j][3] * bfhi(raw.y);
                y[4] += cw[j][4] * bflo(raw.z); y[5] += cw[j][5] * bfhi(raw.z); y[6] += cw[j][6] * bflo(raw.w); y[7] += cw[j][7] * bfhi(raw.w);
            }
        }
        const float sc = WROW ? scale * wrow[t] : scale;
#pragma unroll
        for (int e = 0; e < 8; ++e) y[e] = siluf(y[e]) * sc;
        v4u o; o.x = pk2(y[0], y[1]); o.y = pk2(y[2], y[3]); o.z = pk2(y[4], y[5]); o.w = pk2(y[6], y[7]);
        *(LAS v4u*)(tile + off256(t, ch16)) = o;
    }
}
__device__ __forceinline__ void fill_tile(Frame& F, LAS unsigned char* tile, const bf16* src, size_t row_stride) {
    const int ch16 = F.tid & 15;
#pragma unroll
    for (int it = 0; it < 4; ++it) { const int t = (F.tid >> 4) + 32 * it; *(LAS v4u*)(tile + off256(t, ch16)) = *(const v4u*)(src + (size_t)t * row_stride + 8 * ch16); }
}
__device__ __forceinline__ void mlstm_gates(Frame& F, LAS float* xa, int b, int hh, int t0) {
    if (F.tid < 128) { const size_t row = (size_t)(b * SEQ + t0 + F.tid); xa[F.tid] = F.gates[row * 8 + 4 + hh]; xa[128 + F.tid] = F.gates[row * 8 + hh]; }
    __syncthreads();
    if (F.tid < 128) { float bs = 0.f; for (int s = 0; s <= F.tid; ++s) bs += xa[s]; xa[256 + F.tid] = bs; xa[384 + F.tid] = xa[128 + F.tid] - bs; }
    __syncthreads();
}
__device__ __forceinline__ void mlstm_local_unit(Frame& F, int unit) {
    const int b = unit >> 6, hh = (unit >> 4) & 3, ch = unit & 15, t0 = ch * 128;
    LAS float* xa = (LAS float*)(F.lds + XTRA_OFF);
    LAS unsigned char* KW = F.lds; LAS unsigned char* VT = F.lds + 32768;
    mlstm_gates(F, xa, b, hh, t0);
    float A = -1e30f;
    for (int s = 0; s < 128; ++s) A = fmaxf(A, xa[384 + s]);
    if (F.tid < 128) xa[512 + F.tid] = __expf(xa[384 + F.tid] - A);
    __syncthreads();
    fill_conv_tile<true>(F, KW, F.U + 5 * GRP, b, t0, hh, 512, KSCALE, xa + 512);
    fill_tile(F, VT, F.U + 6 * GRP + (size_t)(b * SEQ + t0) * 512 + hh * 128, 512);
    __syncthreads();
    const int w = F.wave, fr = F.lane & 15, fq = F.lane >> 4, bo = 8 * (fr & 1), cs = (fr & 3) >> 1;
    f32x4 acc[8];
#pragma unroll
    for (int n = 0; n < 8; ++n) acc[n] = (f32x4){0.f, 0.f, 0.f, 0.f};
#pragma unroll
    for (int ks = 0; ks < 4; ++ks) {
        const int r0 = 32 * ks + 8 * fq + (fr >> 2), r1 = r0 + 4;
        const bf16x8 a = cat44(tr16(KW + off256(r0, 2 * w + cs) + bo), tr16(KW + off256(r1, 2 * w + cs) + bo));
#pragma unroll
        for (int n = 0; n < 8; ++n) { const bf16x8 bb = cat44(tr16(VT + off256(r0, 2 * n + cs) + bo), tr16(VT + off256(r1, 2 * n + cs) + bo)); acc[n] = __builtin_amdgcn_mfma_f32_16x16x32_bf16(a, bb, acc[n], 0, 0, 0); }
    }
    float* dC = F.dC + (size_t)unit * 16384;
#pragma unroll
    for (int n = 0; n < 8; ++n)
#pragma unroll
        for (int i = 0; i < 4; ++i) dC[(16 * w + 4 * fq + i) * 128 + 16 * n + fr] = acc[n][i];
    if (F.tid < 128) { float s = 0.f; for (int t = 0; t < 128; ++t) s += bf2f(*(LAS const unsigned short*)(KW + off256(t, F.tid >> 3) + (F.tid & 7) * 2)); F.dn[(size_t)unit * 128 + F.tid] = s; }
    if (F.tid == 0) { F.chA[unit] = A; F.chB[unit] = xa[256 + 127]; }
    __syncthreads();
}
__device__ __forceinline__ void mlstm_scan_unit(Frame& F, int unit) {
    const int seq = unit >> 2, qd = unit & 3, e0 = qd * 4096 + F.tid * 8, dk = qd * 32 + F.tid;
    f32x4 c0 = {0.f, 0.f, 0.f, 0.f}, c1 = c0; float nn = 0.f, m = 0.f;
    for (int ch = 0; ch < 16; ++ch) {
        const int cu = seq * 16 + ch; const float A = F.chA[cu], bl = F.chB[cu], g = fmaxf(m, A), dec = __expf(m - g), sc = __expf(A - g);
        v4u o; o.x = pk2(c0.x, c0.y); o.y = pk2(c0.z, c0.w); o.z = pk2(c1.x, c1.y); o.w = pk2(c1.z, c1.w);
        *(v4u*)(F.cprev + (size_t)cu * 16384 + e0) = o;
        if (F.tid < 32) F.nprev[(size_t)cu * 128 + dk] = nn;
        if (qd == 0 && F.tid == 0) F.mprev[cu] = m;
        const f32x4 d0 = *(const f32x4*)(F.dC + (size_t)cu * 16384 + e0), d1 = *(const f32x4*)(F.dC + (size_t)cu * 16384 + e0 + 4);
        c0 = c0 * dec + d0 * sc; c1 = c1 * dec + d1 * sc;
        if (F.tid < 32) nn = nn * dec + F.dn[(size_t)cu * 128 + dk] * sc;
        m = bl + g;
    }
    float* pc = F.out + O_PC + (size_t)seq * 16384 + e0; *(f32x4*)pc = c0; *(f32x4*)(pc + 4) = c1;
    if (F.tid < 32) F.out[O_PN + (size_t)seq * 128 + dk] = nn;
    if (qd == 0 && F.tid == 0) F.out[O_PM + seq] = m;
}
__device__ __forceinline__ void mlstm_out_unit(Frame& F, int unit) {
    const int b = unit >> 6, hh = (unit >> 4) & 3, ch = unit & 15, t0 = ch * 128;
    LAS float* xa = (LAS float*)(F.lds + XTRA_OFF);
    LAS unsigned char* QT = F.lds; LAS unsigned char* KT = F.lds + 32768; LAS unsigned char* VT = F.lds + 65536; LAS unsigned char* CT = F.lds + 98304;
    mlstm_gates(F, xa, b, hh, t0);
    const float mp = F.mprev[unit];
    if (F.tid < 128) { float cm = -1e30f; for (int s = 0; s <= F.tid; ++s) cm = fmaxf(cm, xa[384 + s]); const float g = fmaxf(mp, cm);
        xa[512 + F.tid] = g; xa[640 + F.tid] = __expf(mp - g); xa[768 + F.tid] = xa[256 + F.tid] + g; xa[896 + F.tid] = F.nprev[(size_t)unit * 128 + F.tid]; }
    fill_conv_tile<false>(F, QT, F.U + 4 * GRP, b, t0, hh, 0, 1.f, xa);
    fill_conv_tile<false>(F, KT, F.U + 5 * GRP, b, t0, hh, 512, KSCALE, xa);
    fill_tile(F, VT, F.U + 6 * GRP + (size_t)(b * SEQ + t0) * 512 + hh * 128, 512);
    fill_tile(F, CT, F.cprev + (size_t)unit * 16384, 128);
    __syncthreads();
    const int w = F.wave, fr = F.lane & 15, fq = F.lane >> 4, bo = 8 * (fr & 1), cs = (fr & 3) >> 1, t = 16 * w + fr;
    bf16x8 qf[4];
#pragma unroll
    for (int ks = 0; ks < 4; ++ks) qf[ks] = *(LAS const bf16x8*)(QT + off256(t, 4 * ks + fq));
    f32x4 accI[8];
#pragma unroll
    for (int n = 0; n < 8; ++n) accI[n] = (f32x4){0.f, 0.f, 0.f, 0.f};
    const float inter = xa[640 + t], mt = xa[768 + t];
    float qn = 0.f;
#pragma unroll
    for (int ks = 0; ks < 4; ++ks) {
        const int r0 = 32 * ks + 8 * fq + (fr >> 2), r1 = r0 + 4;
#pragma unroll
        for (int n = 0; n < 8; ++n) { const bf16x8 cf = cat44(tr16(CT + off256(r0, 2 * n + cs) + bo), tr16(CT + off256(r1, 2 * n + cs) + bo)); accI[n] = __builtin_amdgcn_mfma_f32_16x16x32_bf16(cf, qf[ks], accI[n], 0, 0, 0); }
        const f32x4 n0 = *(LAS const f32x4*)(xa + 896 + 32 * ks + 8 * fq), n1 = *(LAS const f32x4*)(xa + 896 + 32 * ks + 8 * fq + 4);
        const v4u qw = __builtin_bit_cast(v4u, qf[ks]);
        qn += bflo(qw.x) * n0.x + bfhi(qw.x) * n0.y + bflo(qw.y) * n0.z + bfhi(qw.y) * n0.w + bflo(qw.z) * n1.x + bfhi(qw.z) * n1.y + bflo(qw.w) * n1.z + bfhi(qw.w) * n1.w;
    }
#pragma unroll
    for (int n = 0; n < 8; ++n) accI[n] = accI[n] * inter;
    float rowsum = 0.f; const float gt = xa[512 + t];
    for (int st = 0; st <= (w >> 1); ++st) {
        f32x4 p[2];
#pragma unroll
        for (int gg = 0; gg < 2; ++gg) {
            const int g = 2 * st + gg;
            f32x4 sT = {0.f, 0.f, 0.f, 0.f};
#pragma unroll
            for (int ks = 0; ks < 4; ++ks) { const bf16x8 kf = *(LAS const bf16x8*)(KT + off256(16 * g + fr, 4 * ks + fq)); sT = __builtin_amdgcn_mfma_f32_16x16x32_bf16(kf, qf[ks], sT, 0, 0, 0); }
            const f32x4 a4 = *(LAS const f32x4*)(xa + 384 + 16 * g + 4 * fq);
#pragma unroll
            for (int i = 0; i < 4; ++i) { const int sidx = 16 * g + 4 * fq + i; const float d = (sidx <= t) ? __expf(a4[i] - gt) : 0.f; p[gg][i] = sT[i] * d; rowsum += p[gg][i]; }
        }
        const bf16x8 pf = __builtin_bit_cast(bf16x8, (v4u){pk2(p[0][0], p[0][1]), pk2(p[0][2], p[0][3]), pk2(p[1][0], p[1][1]), pk2(p[1][2], p[1][3])});
        const int r0 = 32 * st + 4 * fq + (fr >> 2), r1 = r0 + 16;
#pragma unroll
        for (int n = 0; n < 8; ++n) { const bf16x8 vf = cat44(tr16(VT + off256(r0, 2 * n + cs) + bo), tr16(VT + off256(r1, 2 * n + cs) + bo)); accI[n] = __builtin_amdgcn_mfma_f32_16x16x32_bf16(vf, pf, accI[n], 0, 0, 0); }
    }
    qn += __shfl_xor(qn, 16); qn += __shfl_xor(qn, 32);
    rowsum += __shfl_xor(rowsum, 16); rowsum += __shfl_xor(rowsum, 32);
    const float nq = inter * qn + rowsum, den = fmaxf(fabsf(nq), __expf(-mt)), rden = 1.f / den;
    const size_t rowi = (size_t)(b * SEQ + t0 + t);
    const bf16* OB = F.U + 7 * GRP + rowi * 512 + hh * 128 + 4 * fq; const bf16* ZB = F.U + 8 * GRP + rowi * 512 + hh * 128 + 4 * fq;
    float ssq = 0.f;
#pragma unroll
    for (int n = 0; n < 8; ++n) {
        const u32x2 ov = *(const u32x2*)(OB + 16 * n);
        accI[n][0] = accI[n][0] * rden * sigmf(bflo(ov.x)); accI[n][1] = accI[n][1] * rden * sigmf(bfhi(ov.x));
        accI[n][2] = accI[n][2] * rden * sigmf(bflo(ov.y)); accI[n][3] = accI[n][3] * rden * sigmf(bfhi(ov.y));
        ssq += (accI[n][0] * accI[n][0] + accI[n][1] * accI[n][1]) + (accI[n][2] * accI[n][2] + accI[n][3] * accI[n][3]);
    }
    ssq += __shfl_xor(ssq, 16); ssq += __shfl_xor(ssq, 32);
    const float rs = 1.f / sqrtf(ssq * (1.f / 128.f) + EPS);
#pragma unroll
    for (int n = 0; n < 8; ++n) {
        const u32x2 zv = *(const u32x2*)(ZB + 16 * n); const f32x4 mg = *(const f32x4*)(F.mnorm_g + hh * 128 + 16 * n + 4 * fq);
        u32x2 v; v.x = pk2(accI[n][0] * rs * mg.x * siluf(bflo(zv.x)), accI[n][1] * rs * mg.y * siluf(bfhi(zv.x)));
        v.y = pk2(accI[n][2] * rs * mg.z * siluf(bflo(zv.y)), accI[n][3] * rs * mg.w * siluf(bfhi(zv.y)));
        *(u32x2*)(F.hn + rowi * 1024 + 512 + hh * 128 + 16 * n + 4 * fq) = v;
    }
    __syncthreads();
}

__device__ __forceinline__ void sample_att_unit(Frame& F, int unit) {
    const int b = unit >> 3, h = unit & 7;
    LAS float* sq = (LAS float*)F.lds;
    LAS float* pb = sq + 1024;
    LAS float* red = pb + 2048;
    if (F.tid < 256) {
        const int t = F.tid >> 6, d = F.tid & 63; const float* ur = F.us + (size_t)(4 * b + t) * NG;
        float qv = ur[h * 64 + d], kv = ur[512 + h * 64 + d]; const float vv = ur[1024 + h * 64 + d];
        if (d < 16) {
            const float c = F.rope[(2048 + t) * 8 + (d & 7)], s = F.rope[(2052 + 2048 + t) * 8 + (d & 7)];
            const float qo = ur[h * 64 + (d ^ 8)], ko = ur[512 + h * 64 + (d ^ 8)];
            if (d < 8) { qv = qv * c - qo * s; kv = kv * c - ko * s; } else { qv = qv * c + qo * s; kv = kv * c + ko * s; }
        }
        sq[t * 64 + d] = qv * 0.125f; sq[256 + t * 64 + d] = kv; sq[512 + t * 64 + d] = vv;
        F.out[O_SK + ((size_t)b * WINB + 2044 + t) * 512 + h * 64 + d] = kv; F.out[O_SV + ((size_t)b * WINB + 2044 + t) * 512 + h * 64 + d] = vv;
    }
    __syncthreads();
    const int t = F.wave & 3, half = F.wave >> 2, e0 = half * 194, e1 = half ? 387 : 194;
    float sc[4]; float mloc = -1e30f;
#pragma unroll
    for (int it = 0; it < 4; ++it) {
        const int e = e0 + F.lane + 64 * it; float dot = -1e30f;
        if (e < e1) {
            const int pi = e / 129, j = e - 129 * pi, idx = WINB + t - (j << (2 * pi));
            dot = 0.f;
            if (idx >= WINB) { const LAS float* kp = sq + 256 + (idx - WINB) * 64; for (int d = 0; d < 64; ++d) dot += sq[t * 64 + d] * kp[d]; }
            else { const f32x4* kp = (const f32x4*)(F.ck + ((size_t)b * WINB + idx) * 512 + h * 64);
#pragma unroll
                for (int d4 = 0; d4 < 16; ++d4) { const f32x4 kv = kp[d4]; const f32x4 qv = *(const LAS f32x4*)(sq + t * 64 + 4 * d4); dot += (kv.x * qv.x + kv.y * qv.y) + (kv.z * qv.z + kv.w * qv.w); } }
        }
        sc[it] = dot; mloc = fmaxf(mloc, dot);
    }
    const float m = wave_max(mloc); float ps = 0.f;
#pragma unroll
    for (int it = 0; it < 4; ++it) { const int e = e0 + F.lane + 64 * it; const float p = (e < e1) ? __expf(sc[it] - m) : 0.f; ps += p; pb[F.wave * 256 + F.lane + 64 * it] = p; }
    ps = wave_sum(ps);
    LDS_WAIT();
    float acc = 0.f;
    for (int e = e0; e < e1; ++e) {
        const int pi = e / 129, j = e - 129 * pi, idx = WINB + t - (j << (2 * pi));
        const float p = pb[F.wave * 256 + (e - e0)];
        const float v = (idx >= WINB) ? sq[512 + (idx - WINB) * 64 + F.lane] : F.cv[((size_t)b * WINB + idx) * 512 + h * 64 + F.lane];
        acc += p * v;
    }
    if (F.lane == 0) { red[F.wave * 66] = m; red[F.wave * 66 + 1] = ps; }
    red[F.wave * 66 + 2 + F.lane] = acc;
    __syncthreads();
    if (F.wave < 4) {
        const float m0 = red[F.wave * 66], m1 = red[(F.wave + 4) * 66], M = fmaxf(m0, m1), a0 = __expf(m0 - M), a1 = __expf(m1 - M);
        const float o = (a0 * red[F.wave * 66 + 2 + F.lane] + a1 * red[(F.wave + 4) * 66 + 2 + F.lane]) / (a0 * red[F.wave * 66 + 1] + a1 * red[(F.wave + 4) * 66 + 1]);
        const float za = F.us[(size_t)(4 * b + t) * NG + 1536 + h * 64 + F.lane];
        F.yms[(size_t)(4 * b + t) * 1024 + h * 64 + F.lane] = (bf16)f2bf(o * siluf(za));
    }
    __syncthreads();
}
__device__ __forceinline__ void sample_mlstm_unit(Frame& F, int unit) {
    const int b = unit >> 2, hh = unit & 3;
    LAS float* sm = (LAS float*)F.lds;
    for (int idx = F.tid; idx < 1024; idx += NWAVES * 64) {
        const int t = idx >> 8, isk = (idx >> 7) & 1, dk = idx & 127, c = isk * 512 + hh * 128 + dk, ucol = (isk ? 2560 : 2048) + hh * 128 + dk;
        float y = F.conv_b[c];
#pragma unroll
        for (int j = 0; j < 4; ++j) { const int r = t + j; const float x = (r < 3) ? F.sconv[(size_t)(b * 3 + r) * 1024 + c] : F.us[(size_t)(4 * b + r - 3) * NG + ucol]; y += F.conv_w[j * 1024 + c] * x; }
        sm[isk * 512 + t * 128 + dk] = siluf(y) * (isk ? KSCALE : 1.f);
        if (t >= 1) F.out[O_SCONV + (size_t)(b * 3 + t - 1) * 1024 + c] = F.us[(size_t)(4 * b + t) * NG + ucol];
    }
    { const int t = F.tid >> 7, dv = F.tid & 127; sm[1024 + t * 128 + dv] = F.us[(size_t)(4 * b + t) * NG + 3072 + hh * 128 + dv]; }
    const float m0 = F.sm[b * 4 + hh];
    if (F.tid < 4) {
        float bs = 0.f, cm = -1e30f, iv = 0.f;
        for (int s = 0; s <= F.tid; ++s) { const float* gr = F.gates + (size_t)(MTOK + 4 * b + s) * 8; iv = gr[hh]; bs += gr[4 + hh]; cm = fmaxf(cm, iv - bs); }
        const float mt = fmaxf(m0 + bs, bs + cm);
        sm[1600 + F.tid] = iv; sm[1604 + F.tid] = bs; sm[1608 + F.tid] = mt; sm[1612 + F.tid] = __expf(m0 + bs - mt);
    }
    __syncthreads();
#pragma unroll
    for (int pp = 0; pp < 2; ++pp) { const int p = 2 * F.wave + pp, t = p >> 2, s = p & 3;
        float v = sm[t * 128 + F.lane] * sm[512 + s * 128 + F.lane] + sm[t * 128 + 64 + F.lane] * sm[512 + s * 128 + 64 + F.lane]; v = wave_sum(v); if (F.lane == 0) sm[1536 + p] = v; }
    if (F.wave < 4) { const float* n0 = F.sn + (size_t)(b * 4 + hh) * 128; float v = sm[F.wave * 128 + F.lane] * n0[F.lane] + sm[F.wave * 128 + 64 + F.lane] * n0[64 + F.lane]; v = wave_sum(v); if (F.lane == 0) sm[1552 + F.wave] = v; }
    __syncthreads();
    const int t = F.tid >> 7, dv = F.tid & 127;
    const float* C0 = F.sC + (size_t)(b * 4 + hh) * 16384;
    float acc = 0.f;
    for (int dk = 0; dk < 128; ++dk) acc += sm[t * 128 + dk] * C0[dk * 128 + dv];
    float intra = 0.f, rsum = 0.f; const float Bt = sm[1604 + t], Mt = sm[1608 + t], It = sm[1612 + t];
    for (int s = 0; s <= t; ++s) { const float sqk = sm[1536 + t * 4 + s] * __expf(Bt - sm[1604 + s] + sm[1600 + s] - Mt); intra += sqk * sm[1024 + s * 128 + dv]; rsum += sqk; }
    const float nq = It * sm[1552 + t] + rsum, den = fmaxf(fabsf(nq), __expf(-Mt)), hval = (It * acc + intra) / den;
    const float* ur = F.us + (size_t)(4 * b + t) * NG;
    const float hg = sigmf(ur[3584 + hh * 128 + dv]) * hval;
    { const float q = wave_sum(hg * hg); if (F.lane == 0) sm[1560 + F.wave] = q; }
    __syncthreads();
    const float ms = (sm[1560 + 2 * t] + sm[1560 + 2 * t + 1]) * (1.f / 128.f);
    F.yms[(size_t)(4 * b + t) * 1024 + 512 + hh * 128 + dv] = (bf16)f2bf(hg * (1.f / sqrtf(ms + EPS)) * F.mnorm_g[hh * 128 + dv] * siluf(ur[4096 + hh * 128 + dv]));
    const float B3 = sm[1607], M3 = sm[1611], decay = __expf(m0 + B3 - M3);
    float ws[4];
#pragma unroll
    for (int s = 0; s < 4; ++s) ws[s] = __expf(B3 - sm[1604 + s] + sm[1600 + s] - M3);
    for (int idx = F.tid; idx < 16384; idx += NWAVES * 64) { const int dk = idx >> 7, d2 = idx & 127; float c = decay * C0[idx];
#pragma unroll
        for (int s = 0; s < 4; ++s) c += ws[s] * sm[512 + s * 128 + dk] * sm[1024 + s * 128 + d2];
        F.out[O_SC + (size_t)(b * 4 + hh) * 16384 + idx] = c; }
    if (F.tid < 128) { float n = decay * F.sn[(size_t)(b * 4 + hh) * 128 + F.tid];
#pragma unroll
        for (int s = 0; s < 4; ++s) n += ws[s] * sm[512 + s * 128 + F.tid];
        F.out[O_SN + (size_t)(b * 4 + hh) * 128 + F.tid] = n; }
    if (F.tid == 0) F.out[O_SM + b * 4 + hh] = M3;
    __syncthreads();
}
__device__ __forceinline__ void final_norm_row(Frame& F, const float* src, float* dst, const f32x4 (&g)[4]) {
    const GAS f32x4* xr = (const GAS f32x4*)src + F.lane; f32x4 v[4]; float s = 0.f;
#pragma unroll
    for (int j = 0; j < 4; ++j) { v[j] = xr[64 * j]; s += (v[j].x * v[j].x + v[j].y * v[j].y) + (v[j].z * v[j].z + v[j].w * v[j].w); }
    const float rstd = 1.f / sqrtf(wave_sum(s) * (1.f / 1024.f) + EPS);
    GAS f32x4* o = (GAS f32x4*)dst + F.lane;
#pragma unroll
    for (int j = 0; j < 4; ++j) o[64 * j] = v[j] * g[j] * rstd;
}

struct Args { const float* in[17]; float* out; unsigned char* ws; int ph_lo, ph_hi, li, pad; };
__global__ void __launch_bounds__(NWAVES * 64, 2) hymba_fwd(Args args) {
    extern __shared__ __attribute__((aligned(16))) unsigned char lds[];
    Frame F;
    F.lds = (LAS unsigned char*)lds;
    F.MISC = (volatile LAS unsigned*)(F.lds + MISC_OFF);
    F.tid = threadIdx.x; F.lane = F.tid & 63; F.wave = __builtin_amdgcn_readfirstlane(F.tid >> 6);
    F.G = gridDim.x; { const int bx = blockIdx.x; F.vcu = (F.G % 8 == 0) ? (bx % 8) * (F.G / 8) + bx / 8 : bx; }
    unsigned char* ws = args.ws; F.ws = ws; F.out = args.out;
    F.ctl = (unsigned*)(ws + WS_CTL);
    F.xp = args.in[0]; F.xs = args.in[1]; F.ck = args.in[2]; F.cv = args.in[3]; F.sconv = args.in[4]; F.sC = args.in[5]; F.sn = args.in[6]; F.sm = args.in[7];
    F.norm_g = args.in[8]; F.w_in = args.in[9]; F.conv_w = args.in[10]; F.conv_b = args.in[11]; F.b_i = args.in[12]; F.b_f = args.in[13]; F.mnorm_g = args.in[14]; F.w_out = args.in[15]; F.fnorm_g = args.in[16];
    F.wt_in = (bf16*)(ws + WS_WTIN); F.wt_out = (bf16*)(ws + WS_WTOUT); F.hn = (bf16*)(ws + WS_HN); F.U = (bf16*)(ws + WS_U); F.po16 = (bf16*)(ws + WS_PO16); F.po4 = (bf16*)(ws + WS_PO4);
    F.hns = (bf16*)(ws + WS_HNS); F.yms = (bf16*)(ws + WS_YMS);
    F.rope = (float*)(ws + WS_ROPE); F.gates = (float*)(ws + WS_GATES); F.rowss = (float*)(ws + WS_ROWSS); F.us = (float*)(ws + WS_US); F.yps = (float*)(ws + WS_YPS);
    F.chA = (float*)(ws + WS_CHA); F.chB = F.chA + 1024; F.mprev = F.chA + 2048; F.dn = (float*)(ws + WS_DN); F.nprev = (float*)(ws + WS_NPREV); F.pl = (float*)(ws + WS_PL);
    F.dC = args.out; F.cprev = (bf16*)((unsigned char*)args.out + 64 * MiB);
    for (int u = F.tid; u < (LDS_BYTES - LDSCTL_OFF) / 4; u += NWAVES * 64) ((LAS unsigned*)(F.lds + LDSCTL_OFF))[u] = 0u;
    __syncthreads();
    const bool one_phase = (args.ph_hi - args.ph_lo) == 1;
    XcdBarrier bar; bar.bar = (unsigned*)(F.ctl + CW_BAR); bar.x = 0; bar.st = nullptr;
    if (!one_phase) bar = xcd_barrier_post((unsigned*)(F.ctl + CW_BAR), F.MISC + 8);
    const int lo = args.ph_lo, hi = args.ph_hi;
#define IN(k) (lo <= (k) && (k) < hi)
#define SEAM(k) do { if (IN(k) && IN((k) + 1)) xcd_barrier(bar); } while (0)

    if (IN(0)) { p0_prologue(F); }
    SEAM(0);
    if (IN(1)) {
        pg8::Gemm g{F.hn, F.wt_in, MTOK, NG, DM}; pg8::StaticOrder S; S.init(MTOK, NG, F.G, (int)blockIdx.x);
        pg8::EpiIn E{F.U, F.out + O_PK, F.out + O_PV, F.out + O_PCONV, F.rope, C2};
        pg8::gemm_phase<pg8::EpiIn, pg8::StaticOrder, true, true>(F.lds + RING_OFF, g, S, E);
        small_gemm(F, F.hns, F.wt_in, NG, DM, F.us, NG, nullptr);
    }
    SEAM(1);
    if (IN(2)) {
        att_phase<0>(F, 4, 2, 4096);
        for (int i = F.vcu; i < 1024; i += F.G) mlstm_local_unit(F, i);
        for (int i = F.vcu; i < NSB * 8; i += F.G) sample_att_unit(F, i);
        for (int i = F.vcu; i < NSB * 4; i += F.G) sample_mlstm_unit(F, i);
    }
    SEAM(2);
    if (IN(3)) {
        for (int i = F.vcu; i < 256; i += F.G) mlstm_scan_unit(F, i);
        att_phase<1>(F, 0, 0, 2048);
        small_gemm(F, F.yms, F.wt_out, DM, DM, F.yps, DM, F.xs);
    }
    SEAM(3);
    if (IN(4)) { for (int i = F.vcu; i < 1024; i += F.G) mlstm_out_unit(F, i); }
    SEAM(4);
    if (IN(5)) {
        pg8::Gemm g{F.hn, F.wt_out, MTOK, DM, DM}; pg8::StaticOrder S; S.init(MTOK, DM, F.G, (int)blockIdx.x);
        pg8::EpiOut E{F.xp, F.out + O_YP};
        pg8::gemm_phase<pg8::EpiOut, pg8::StaticOrder, true, true>(F.lds + RING_OFF, g, S, E);
    }
    SEAM(5);
    if (IN(6)) {
        f32x4 g[4];
#pragma unroll
        for (int j = 0; j < 4; ++j) g[j] = ((const f32x4*)F.fnorm_g)[F.lane + 64 * j];
        const int gwv = F.vcu * NWAVES + F.wave, NGW = F.G * NWAVES;
        for (int m = gwv; m < MTOK + MS; m += NGW) {
            if (m < MTOK) final_norm_row(F, F.out + O_YP + (size_t)m * DM, F.out + O_YP + (size_t)m * DM, g);
            else final_norm_row(F, F.yps + (size_t)(m - MTOK) * DM, F.out + O_YS + (size_t)(m - MTOK) * DM, g);
        }
    }
#undef IN
#undef SEAM
}

extern "C" void kernel_launch(void* const* d_in, const int* in_sizes, int n_in, void* d_out, int out_size, void* d_ws, size_t ws_size, hipStream_t stream) {
    static int grid = 0;
    if (grid == 0) {
        if (n_in != 17 || (size_t)out_size != O_END || ws_size < WS_END) { fprintf(stderr, "kernel_launch: unexpected shapes (n_in %d, out %d, ws %zu); nothing launched\n", n_in, out_size, ws_size); grid = -1; return; }
        int dev = 0, cus = 0;
        if (hipGetDevice(&dev) != hipSuccess || hipDeviceGetAttribute(&cus, hipDeviceAttributeMultiprocessorCount, dev) != hipSuccess) { grid = -1; return; }
        if (hipFuncSetAttribute((const void*)hymba_fwd, hipFuncAttributeMaxDynamicSharedMemorySize, LDS_BYTES) != hipSuccess) { fprintf(stderr, "kernel_launch: hipFuncSetAttribute failed\n"); grid = -1; return; }
        (void)hipGetLastError();
        grid = cus;
    }
    if (grid < 0) return;
    if (hipMemsetAsync((char*)d_ws + WS_CTL, 0, CTL_ZERO_BYTES, stream) != hipSuccess) return;
    Args a{};
    for (int i = 0; i < 17; ++i) a.in[i] = (const float*)d_in[i];
    a.out = (float*)d_out; a.ws = (unsigned char*)d_ws;
    constexpr int NL = MK_N_LAUNCHES;
#ifndef MK_LAST
#define MK_LAST 99
#endif
    for (int li = 0; li < NL && li < MK_LAST; ++li) {
        a.ph_lo = (NL == 1) ? 0 : li; a.ph_hi = (NL == 1) ? N_PHASES : li + 1; a.li = li;
        hipLaunchKernelGGL(hymba_fwd, dim3(grid), dim3(NWAVES * 64), LDS_BYTES, stream, a);
    }
}
```
